# Optimizing an MI355X kernel written in HIP

```python
import jax, jax.numpy as jnp
from jax import lax
import numpy as np


D_MODEL = 2048
BATCH = 4
SEQ = 4096
DEPTH = 1

GRID_W = 64
PLE_DIM = 256
NA_HEADS = 8
NA_HEAD_DIM = 128
NA_WIN_H = 8
NA_WIN_W = 16
NA_WIDTH = NA_HEADS * NA_HEAD_DIM
MLA_HEADS = 8
MLA_NOPE_DIM = 128
MLA_ROPE_DIM = 64
MLA_V_DIM = 128
MLA_QK_DIM = MLA_NOPE_DIM + MLA_ROPE_DIM
Q_LORA_RANK = 512
KV_LORA_RANK = 512
MLA_WIDTH = MLA_HEADS * MLA_V_DIM
ROPE_THETA = 10000.0
Q_BLOCK = 128
MIX_WIDTH = NA_WIDTH + MLA_WIDTH
IN_WIDTH = 3 * NA_WIDTH + Q_LORA_RANK + KV_LORA_RANK + MLA_ROPE_DIM
N_GROUPS = 8
EXPERTS_PER_GROUP = 8
N_EXPERTS = N_GROUPS * EXPERTS_PER_GROUP
TOP_K_EXPERT = 2
D_EXPERT = 512
MOE_BLOCK = 256
ALPHA = (2 * DEPTH) ** 0.25
BETA = (8 * DEPTH) ** -0.25
LN_EPS = 1e-5
RMS_EPS = 1e-6

kernel_name = 'hybrid_na_mla_hmoe_block'


def layer_norm(x, g, b):
    xf = x.astype(jnp.float32)
    mu = jnp.mean(xf, axis=-1, keepdims=True)
    var = jnp.mean(jnp.square(xf - mu), axis=-1, keepdims=True)
    y = (xf - mu) * lax.rsqrt(var + LN_EPS)
    return (y * g.astype(jnp.float32) + b.astype(jnp.float32)).astype(x.dtype)


def rms_norm(x, g):
    xf = x.astype(jnp.float32)
    y = xf * lax.rsqrt(jnp.mean(jnp.square(xf), axis=-1, keepdims=True) + RMS_EPS)
    return (y * g.astype(jnp.float32)).astype(x.dtype)


def rope_tables(positions, dtype):
    inv_freq = 1.0 / (ROPE_THETA ** (jnp.arange(0, MLA_ROPE_DIM, 2, dtype=jnp.float32) / MLA_ROPE_DIM))
    ang = positions.astype(jnp.float32)[..., None] * inv_freq
    return jnp.cos(ang).astype(dtype), jnp.sin(ang).astype(dtype)


def apply_rope(x, cos, sin):
    x1, x2 = jnp.split(x, 2, axis=-1)
    return jnp.concatenate([x1 * cos - x2 * sin, x1 * sin + x2 * cos], axis=-1)


def neighbourhood_attention(q, k, v, rpb):
    B, S, H, Dh = q.shape
    rows = S // GRID_W
    kh = min(NA_WIN_H, rows)
    kw = NA_WIN_W
    scale = Dh ** -0.5
    qg = q.reshape(B, rows, GRID_W, H, Dh)
    kg = k.reshape(B, rows, GRID_W, H, Dh)
    vg = v.reshape(B, rows, GRID_W, H, Dh)
    col = jnp.arange(GRID_W)
    c0 = jnp.clip(col - kw // 2, 0, GRID_W - kw)
    col_idx = c0[:, None] + jnp.arange(kw)[None, :]
    col_off = col_idx - col[:, None] + (NA_WIN_W - 1)
    rpb_c = rpb[:, :, col_off]
    r0 = jnp.clip(jnp.arange(rows) - kh // 2, 0, rows - kh)

    def one_row(r):
        start = r0[r]
        q_r = lax.dynamic_index_in_dim(qg, r, axis=1, keepdims=False)
        k_rows = lax.dynamic_slice_in_dim(kg, start, kh, axis=1)
        v_rows = lax.dynamic_slice_in_dim(vg, start, kh, axis=1)
        k_win = k_rows[:, :, col_idx]
        v_win = v_rows[:, :, col_idx]
        row_off = start + jnp.arange(kh) - r + (NA_WIN_H - 1)
        bias = rpb_c[:, row_off].transpose(0, 2, 1, 3)
        s = jnp.einsum('bqhd,brqwhd->bhqrw', q_r, k_win).astype(jnp.float32) * scale
        s = s + bias.astype(jnp.float32)[None]
        pr = jax.nn.softmax(s.reshape(B, H, GRID_W, kh * kw), axis=-1)
        pr = pr.reshape(s.shape).astype(v.dtype)
        return jnp.einsum('bhqrw,brqwhd->bqhd', pr, v_win)

    out = lax.map(one_row, jnp.arange(rows))
    return out.transpose(1, 0, 2, 3, 4).reshape(B, S, H * Dh)


def dense_attention_blocked(q, k, v, scale):
    B, S, H, Dq = q.shape
    Dv = v.shape[-1]
    qb = q.reshape(B, S // Q_BLOCK, Q_BLOCK, H, Dq).transpose(1, 0, 2, 3, 4)

    def block(qi):
        s = jnp.einsum('bqhd,bkhd->bhqk', qi, k).astype(jnp.float32) * scale
        pr = jax.nn.softmax(s, axis=-1).astype(v.dtype)
        return jnp.einsum('bhqk,bkhd->bqhd', pr, v)

    o = lax.map(block, qb)
    return o.transpose(1, 0, 2, 3, 4).reshape(B, S, H * Dv)


def token_mixer(h, cos, sin, w_in, rpb, q_norm_g, kv_norm_g, w_uq, w_uk, w_uv, w_o):
    B, S, _ = h.shape
    proj = jnp.einsum('bsd,df->bsf', h, w_in)
    s1 = NA_WIDTH
    s2 = 2 * NA_WIDTH
    s3 = 3 * NA_WIDTH
    s4 = s3 + Q_LORA_RANK
    s5 = s4 + KV_LORA_RANK
    q_na = proj[..., :s1].reshape(B, S, NA_HEADS, NA_HEAD_DIM)
    k_na = proj[..., s1:s2].reshape(B, S, NA_HEADS, NA_HEAD_DIM)
    v_na = proj[..., s2:s3].reshape(B, S, NA_HEADS, NA_HEAD_DIM)
    c_q = proj[..., s3:s4]
    c_kv = proj[..., s4:s5]
    k_r = proj[..., s5:]
    o_na = neighbourhood_attention(q_na, k_na, v_na, rpb)
    q = jnp.einsum('bsr,rf->bsf', rms_norm(c_q, q_norm_g), w_uq).reshape(B, S, MLA_HEADS, MLA_QK_DIM)
    q_nope, q_pe = q[..., :MLA_NOPE_DIM], q[..., MLA_NOPE_DIM:]
    q_pe = apply_rope(q_pe, cos[:, :, None, :], sin[:, :, None, :])
    c_kv = rms_norm(c_kv, kv_norm_g)
    k_nope = jnp.einsum('bsr,rf->bsf', c_kv, w_uk).reshape(B, S, MLA_HEADS, MLA_NOPE_DIM)
    v = jnp.einsum('bsr,rf->bsf', c_kv, w_uv).reshape(B, S, MLA_HEADS, MLA_V_DIM)
    k_pe = apply_rope(k_r, cos, sin)
    k_pe = jnp.broadcast_to(k_pe[:, :, None, :], (B, S, MLA_HEADS, MLA_ROPE_DIM))
    q_full = jnp.concatenate([q_nope, q_pe], axis=-1)
    k_full = jnp.concatenate([k_nope, k_pe], axis=-1)
    o_mla = dense_attention_blocked(q_full, k_full, v, MLA_QK_DIM ** -0.5)
    o = jnp.concatenate([o_na, o_mla], axis=-1)
    return jnp.einsum('bsf,fd->bsd', o, w_o)


def hier_moe(h, w_group, b_group, w_router, b_router, w_gate, w_up, w_down):
    B, S, D = h.shape
    N = B * S
    t = h.reshape(N, D)
    g_prob = jax.nn.softmax(jnp.einsum('nd,dg->ng', t, w_group).astype(jnp.float32) + b_group.astype(jnp.float32), axis=-1)
    g_val, g_idx = lax.top_k(g_prob, 1)
    e_logits = jnp.einsum('nd,de->ne', t, w_router).astype(jnp.float32).reshape(N, N_GROUPS, EXPERTS_PER_GROUP)
    e_logits = e_logits + b_router.astype(jnp.float32)
    e_sel = jnp.take_along_axis(e_logits, g_idx[:, :, None], axis=1)[:, 0]
    e_prob = jax.nn.softmax(e_sel, axis=-1)
    e_val, e_idx = lax.top_k(e_prob, TOP_K_EXPERT)
    e_val = e_val / jnp.sum(e_val, axis=-1, keepdims=True)
    gate = g_val * e_val
    eid = g_idx * EXPERTS_PER_GROUP + e_idx
    M = N * TOP_K_EXPERT
    flat_eid = eid.reshape(-1)
    flat_tok = jnp.repeat(jnp.arange(N), TOP_K_EXPERT)
    flat_w = gate.reshape(-1)
    order = jnp.argsort(flat_eid)
    s_eid = flat_eid[order]
    s_tok = flat_tok[order]
    s_w = flat_w[order]
    counts = jnp.bincount(flat_eid, length=N_EXPERTS)
    starts = jnp.cumsum(counts) - counts
    padded = ((counts + MOE_BLOCK - 1) // MOE_BLOCK) * MOE_BLOCK
    pad_ends = jnp.cumsum(padded)
    pad_starts = pad_ends - padded
    pos = pad_starts[s_eid] + (jnp.arange(M) - starts[s_eid])
    n_blocks = (M + N_EXPERTS * (MOE_BLOCK - 1) + MOE_BLOCK - 1) // MOE_BLOCK
    P = n_blocks * MOE_BLOCK
    xs = jnp.zeros((P, D), t.dtype).at[pos].set(t[s_tok])
    block_e = jnp.clip(jnp.searchsorted(pad_ends, jnp.arange(n_blocks) * MOE_BLOCK, side='right'), 0, N_EXPERTS - 1)

    def expert_block(args):
        xb, e = args
        hdn = jax.nn.silu(xb @ w_gate[e]) * (xb @ w_up[e])
        return hdn @ w_down[e]

    ys = lax.map(expert_block, (xs.reshape(n_blocks, MOE_BLOCK, D), block_e)).reshape(P, D)
    y = jnp.zeros((N, D), t.dtype).at[s_tok].add(ys[pos] * s_w[:, None].astype(t.dtype))
    return y.reshape(B, S, D)


def per_layer_embedding(h, p_i, w_ple, w_ple_gate, ple_norm_g):
    gate = jax.nn.sigmoid(jnp.einsum('bsd,de->bse', h, w_ple_gate).astype(jnp.float32))
    e = jnp.einsum('bsq,qd->bsd', p_i, w_ple)
    return rms_norm(e * gate.astype(e.dtype), ple_norm_g)


def setup_inputs(seed: int = 0) -> dict:
    key = jax.random.key(seed)
    ks = jax.random.split(key, 24)

    def nrm(k, shape, scale):
        return jax.random.normal(k, shape, jnp.float32) * scale

    D = D_MODEL
    x = nrm(ks[0], (BATCH, SEQ, D), 1.0)
    p = nrm(ks[1], (DEPTH, BATCH, SEQ, PLE_DIM), 1.0)
    positions = jnp.tile(jnp.arange(SEQ, dtype=jnp.int32)[None, :], (BATCH, 1))
    col_scale = jnp.ones((IN_WIDTH,), jnp.float32).at[2 * NA_WIDTH:3 * NA_WIDTH].set(BETA)
    w_in = nrm(ks[2], (DEPTH, D, IN_WIDTH), D ** -0.5) * col_scale
    rpb = nrm(ks[3], (DEPTH, NA_HEADS, 2 * NA_WIN_H - 1, 2 * NA_WIN_W - 1), 0.02)
    q_norm_g = 1.0 + nrm(ks[4], (DEPTH, Q_LORA_RANK), 0.02)
    kv_norm_g = 1.0 + nrm(ks[5], (DEPTH, KV_LORA_RANK), 0.02)
    w_uq = nrm(ks[6], (DEPTH, Q_LORA_RANK, MLA_HEADS * MLA_QK_DIM), Q_LORA_RANK ** -0.5)
    w_uk = nrm(ks[7], (DEPTH, KV_LORA_RANK, MLA_HEADS * MLA_NOPE_DIM), KV_LORA_RANK ** -0.5)
    w_uv = nrm(ks[8], (DEPTH, KV_LORA_RANK, MLA_HEADS * MLA_V_DIM), KV_LORA_RANK ** -0.5 * BETA)
    w_o = nrm(ks[9], (DEPTH, MIX_WIDTH, D), MIX_WIDTH ** -0.5 * BETA)
    ln1_g = 1.0 + nrm(ks[10], (DEPTH, D), 0.02)
    ln1_b = nrm(ks[11], (DEPTH, D), 0.02)
    w_group = nrm(ks[12], (DEPTH, D, N_GROUPS), D ** -0.5)
    b_group = nrm(ks[13], (DEPTH, N_GROUPS), 0.01)
    w_router = nrm(ks[14], (DEPTH, D, N_EXPERTS), D ** -0.5)
    b_router = nrm(ks[15], (DEPTH, N_GROUPS, EXPERTS_PER_GROUP), 0.01)
    w_gate = nrm(ks[16], (DEPTH, N_EXPERTS, D, D_EXPERT), D ** -0.5)
    w_up = nrm(ks[17], (DEPTH, N_EXPERTS, D, D_EXPERT), D ** -0.5 * BETA)
    w_down = nrm(ks[18], (DEPTH, N_EXPERTS, D_EXPERT, D), D_EXPERT ** -0.5 * BETA)
    ln2_g = 1.0 + nrm(ks[19], (DEPTH, D), 0.02)
    ln2_b = nrm(ks[20], (DEPTH, D), 0.02)
    w_ple = nrm(ks[21], (DEPTH, PLE_DIM, D), PLE_DIM ** -0.5)
    w_ple_gate = nrm(ks[22], (DEPTH, D, D), D ** -0.5)
    ple_norm_g = 1.0 + nrm(ks[23], (DEPTH, D), 0.02)
    return {'x': x, 'p': p, 'positions': positions, 'w_in': w_in, 'rpb': rpb,
            'q_norm_g': q_norm_g, 'kv_norm_g': kv_norm_g, 'w_uq': w_uq, 'w_uk': w_uk,
            'w_uv': w_uv, 'w_o': w_o, 'ln1_g': ln1_g, 'ln1_b': ln1_b,
            'w_group': w_group, 'b_group': b_group, 'w_router': w_router, 'b_router': b_router,
            'w_gate': w_gate, 'w_up': w_up, 'w_down': w_down, 'ln2_g': ln2_g, 'ln2_b': ln2_b,
            'w_ple': w_ple, 'w_ple_gate': w_ple_gate, 'ple_norm_g': ple_norm_g}


def reference(x, p, positions, w_in, rpb, q_norm_g, kv_norm_g, w_uq, w_uk, w_uv, w_o,
              ln1_g, ln1_b, w_group, b_group, w_router, b_router, w_gate, w_up, w_down,
              ln2_g, ln2_b, w_ple, w_ple_gate, ple_norm_g):
    cos, sin = rope_tables(positions, x.dtype)
    for i in range(DEPTH):
        mix = token_mixer(x, cos, sin, w_in[i], rpb[i], q_norm_g[i], kv_norm_g[i],
                          w_uq[i], w_uk[i], w_uv[i], w_o[i])
        x = layer_norm(ALPHA * x + mix, ln1_g[i], ln1_b[i])
        ffn = hier_moe(x, w_group[i], b_group[i], w_router[i], b_router[i],
                       w_gate[i], w_up[i], w_down[i])
        x = layer_norm(ALPHA * x + ffn, ln2_g[i], ln2_b[i])
        x = x + per_layer_embedding(x, p[i], w_ple[i], w_ple_gate[i], ple_norm_g[i])
    return x
```

```cpp
#include <hip/hip_runtime.h>
#include <cstdio>
#include <cstdint>

#define GAS __attribute__((address_space(1)))
#define LAS __attribute__((address_space(3)))
typedef unsigned short bf16;
typedef unsigned v4u __attribute__((ext_vector_type(4)));
typedef unsigned v2u __attribute__((ext_vector_type(2)));
typedef float f32x4 __attribute__((ext_vector_type(4)));
typedef float f32x2 __attribute__((ext_vector_type(2)));
typedef float f32x16 __attribute__((ext_vector_type(16)));
typedef short bf16x8 __attribute__((ext_vector_type(8)));
typedef short s16x4 __attribute__((ext_vector_type(4)));
typedef GAS unsigned gu32;
#define RLX_AGENT __ATOMIC_RELAXED, __HIP_MEMORY_SCOPE_AGENT
#define LDS_WAIT() asm volatile("s_waitcnt lgkmcnt(0)" ::: "memory")
#define VM_WAIT() asm volatile("s_waitcnt vmcnt(0)" ::: "memory")
#define SBAR() __builtin_amdgcn_sched_barrier(0)

constexpr int NB = 4, SEQ = 4096, DM = 2048, NTOK = NB * SEQ;
constexpr int GRIDW = 64, NROWS = SEQ / GRIDW;
constexpr int NAH = 8, NAD = 128, NAW = NAH * NAD;
constexpr int MH = 8, NOPE = 128, ROPE = 64, QKD = NOPE + ROPE, VD = 128, MLAW = MH * VD;
constexpr int QLR = 512, KVLR = 512, PLE = 256;
constexpr int INW = 3 * NAW + QLR + KVLR + ROPE;
constexpr int NEXP = 64, DEXP = 512, NGRP = 8, EPG = 8;
constexpr float ALPHA = 1.189207115002721f;
constexpr float LN_EPS = 1e-5f, RMS_EPS = 1e-6f;
constexpr int MAXP = 49152, MAXT = MAXP / 256;

__device__ __forceinline__ unsigned f2bf(float f) { unsigned u = __builtin_bit_cast(unsigned, f); return (u + 0x7fffu + ((u >> 16) & 1u)) >> 16; }
__device__ __forceinline__ unsigned pk2(float lo, float hi) { return f2bf(lo) | (f2bf(hi) << 16); }
__device__ __forceinline__ float bf2f(unsigned b) { return __builtin_bit_cast(float, b << 16); }
__device__ __forceinline__ unsigned cvt_pk_bf16(float lo, float hi) { unsigned r; asm volatile("v_cvt_pk_bf16_f32 %0, %1, %2" : "=v"(r) : "v"(lo), "v"(hi)); return r; }

namespace pg8 {
#define PG8_LAS __attribute__((address_space(3)))
constexpr int BM = 256, BK = 64, HALF = 128, HTB = HALF * BK * 2  , STAGE_BYTES = 8 * HTB, NXCD = 8, WGM = 8;

__host__ __device__ __forceinline__ int lds_byte(int r, int c) { const int st = (r >> 4) * 2 + (c >> 5), rr = r & 15, cc = c & 31, ob = rr * 64 + cc * 2; return st * 1024 + (ob ^ (((ob >> 9) & 1) << 5)); }
__host__ __device__ __forceinline__ void stage_rc(int b, int& R, int& C) { const int st = b / 1024, sb = b % 1024, swz = sb ^ (((sb >> 9) & 1) << 5); R = (st >> 1) * 16 + swz / 64; C = (st & 1) * 32 + (swz % 64) / 2; }
__host__ __device__ __forceinline__ int perm32(int rho) { const int n = rho >> 4, i = rho & 15; return 8 * (i >> 2) + 4 * n + (i & 3); }

struct Unit { const char* A; const char* B; int pm, pn, tag; };

__device__ __forceinline__ void tile_of(int L, int nM, int nN, int& pm, int& pn) {
    const int nwg = nM * nN; int wgid = L; { const int q = nwg / NXCD, r = nwg % NXCD, xcd = wgid % NXCD, off = wgid / NXCD; wgid = (xcd < r ? xcd * (q + 1) : r * (q + 1) + (xcd - r) * q) + off; }
    const int nig = WGM * nN, gid = wgid / nig, fm = gid * WGM, gsz = (nM - fm) < WGM ? (nM - fm) : WGM;
    pm = fm + ((wgid % nig) % gsz); pn = (wgid % nig) / gsz;
}

template <class Epi, class Sched>
__device__ __forceinline__ void gemm_phase(PG8_LAS unsigned char* lds, const int K, const int lda, const int ldb, const Sched& S, const Epi& E) {
    const int tid = threadIdx.x, wid = __builtin_amdgcn_readfirstlane(tid >> 6), lane = tid & 63, wr = wid >> 2, wc = wid & 3, fr = lane & 15, fq = lane >> 4;
    const int nt = K / BK;
    unsigned voffA[2], voffB[2];
#pragma unroll
    for (int i = 0; i < 2; ++i) { int R, C; stage_rc(tid * 16 + i * 8192, R, C); const int Rb = Epi::PERM ? ((R & ~31) + perm32(R & 31)) : R;
        voffA[i] = (unsigned)(R * lda + C) * 2u; voffB[i] = (unsigned)(Rb * ldb + C) * 2u; }
    const size_t kstep = (size_t)(BK * 2);
    const size_t hstepA = (size_t)HALF * lda * 2, hstepB = (size_t)HALF * ldb * 2;
    const unsigned ldsw = (unsigned)wid * 1024u;
    const int aoff = lds_byte(wr * 64 + fr, fq * 8), boff = lds_byte(wc * 32 + fr, fq * 8);
#define PG8_SA(b, h) (((b) * 2 + (h)) * HTB)
#define PG8_SB(b, h) ((4 + (b) * 2 + (h)) * HTB)
#define PG8_STAGE(bufoff, gbase, voff) do { _Pragma("unroll") for (int _i = 0; _i < 2; ++_i) \
        __builtin_amdgcn_global_load_lds((const unsigned*)((const char*)(gbase) + (voff)[_i]), (PG8_LAS unsigned*)(lds + (bufoff) + ldsw + _i * 8192), 16, 0, 0); } while (0)
#define PG8_LDA(dst, b, h) do { _Pragma("unroll") for (int m = 0; m < 4; ++m) _Pragma("unroll") for (int k = 0; k < 2; ++k) dst[m][k] = *(const PG8_LAS bf16x8*)(lds + PG8_SA(b, h) + aoff + m * 2048 + k * 1024); } while (0)
#define PG8_LDB(dst, b, h) do { _Pragma("unroll") for (int n = 0; n < 2; ++n) _Pragma("unroll") for (int k = 0; k < 2; ++k) dst[n][k] = *(const PG8_LAS bf16x8*)(lds + PG8_SB(b, h) + boff + n * 2048 + k * 1024); } while (0)
#define PG8_MMA(ai, bj, At, Bt) do { __builtin_amdgcn_s_setprio(1); _Pragma("unroll") for (int m = 0; m < 4; ++m) _Pragma("unroll") for (int n = 0; n < 2; ++n) _Pragma("unroll") for (int k = 0; k < 2; ++k) \
        acc[ai][bj][m][n] = __builtin_amdgcn_mfma_f32_16x16x32_bf16(Bt[n][k], At[m][k], acc[ai][bj][m][n], 0, 0, 0); __builtin_amdgcn_s_setprio(0); } while (0)
#define PG8_WAIT_V(n) asm volatile("s_waitcnt vmcnt(" #n ")" ::: "memory")
#define PG8_WAIT_L(n) asm volatile("s_waitcnt lgkmcnt(" #n ")" ::: "memory")
#define PG8_BAR __builtin_amdgcn_s_barrier()
#define PG8_SCHED __builtin_amdgcn_sched_barrier(0)
    Unit cur, nxt; int ui = 0;
    if (!S.next(0, cur)) return;
    f32x4 acc[2][2][4][2];
#pragma unroll
    for (int a = 0; a < 2; ++a)
#pragma unroll
        for (int b = 0; b < 2; ++b)
#pragma unroll
            for (int m = 0; m < 4; ++m)
#pragma unroll
                for (int n = 0; n < 2; ++n) acc[a][b][m][n] = (f32x4){0.f, 0.f, 0.f, 0.f};
    bf16x8 At[4][2], B0[2][2], B1[2][2];
    const char* cA = cur.A; const char* cB = cur.B;
    PG8_STAGE(PG8_SB(0, 0), cB, voffB); PG8_STAGE(PG8_SB(0, 1), cB + hstepB, voffB); PG8_STAGE(PG8_SA(0, 0), cA, voffA); PG8_STAGE(PG8_SA(0, 1), cA + hstepA, voffA);
    if (wr == 1) PG8_BAR;
    PG8_WAIT_V(2); PG8_BAR;
    PG8_STAGE(PG8_SB(1, 0), cB + kstep, voffB); PG8_STAGE(PG8_SA(1, 0), cA + kstep, voffA); PG8_STAGE(PG8_SB(1, 1), cB + hstepB + kstep, voffB);
    PG8_WAIT_V(6); PG8_BAR;
    for (;;) {
        const bool has_next = S.next(ui + 1, nxt);
        const char* nA = has_next ? nxt.A : cA; const char* nB = has_next ? nxt.B : cB;
        for (int t = 0; t < nt; t += 2) {
            const bool last = (t == nt - 2);
            const char* a1 = cA + (size_t)(t + 1) * kstep;
            const char* a2 = last ? nA : cA + (size_t)(t + 2) * kstep; const char* b2 = last ? nB : cB + (size_t)(t + 2) * kstep;
            const char* a3 = a2 + kstep; const char* b3 = b2 + kstep;
            PG8_LDB(B0, 0, 0); PG8_LDB(B1, 0, 1); PG8_SCHED; PG8_LDA(At, 0, 0); PG8_STAGE(PG8_SA(1, 1), a1 + hstepA, voffA);
            PG8_WAIT_V(8); PG8_WAIT_L(0); PG8_BAR; PG8_MMA(0, 0, At, B0); PG8_MMA(0, 1, At, B1); PG8_BAR; PG8_SCHED;
            PG8_LDA(At, 0, 1); PG8_STAGE(PG8_SB(0, 0), b2, voffB); PG8_STAGE(PG8_SB(0, 1), b2 + hstepB, voffB); PG8_STAGE(PG8_SA(0, 0), a2, voffA);
            PG8_WAIT_V(8); PG8_WAIT_L(0); PG8_BAR; PG8_MMA(1, 0, At, B0); PG8_MMA(1, 1, At, B1); PG8_BAR; PG8_SCHED;
            PG8_LDB(B0, 1, 0); PG8_LDB(B1, 1, 1); PG8_SCHED; PG8_LDA(At, 1, 0); PG8_STAGE(PG8_SA(0, 1), a2 + hstepA, voffA);
            PG8_WAIT_V(8); PG8_WAIT_L(0); PG8_BAR; PG8_MMA(0, 0, At, B0); PG8_MMA(0, 1, At, B1); PG8_BAR; PG8_SCHED;
            PG8_LDA(At, 1, 1); PG8_STAGE(PG8_SB(1, 0), b3, voffB); PG8_STAGE(PG8_SB(1, 1), b3 + hstepB, voffB); PG8_STAGE(PG8_SA(1, 0), a3, voffA);
            PG8_WAIT_V(8); PG8_WAIT_L(0); PG8_BAR; PG8_MMA(1, 0, At, B0); PG8_MMA(1, 1, At, B1); PG8_BAR; PG8_SCHED;
        }
        if (wr == 0) PG8_BAR;
        E(acc, cur, wr, wc, fr, fq);
        if (!has_next) break;
#pragma unroll
        for (int a = 0; a < 2; ++a)
#pragma unroll
            for (int b = 0; b < 2; ++b)
#pragma unroll
                for (int m = 0; m < 4; ++m)
#pragma unroll
                    for (int n = 0; n < 2; ++n) acc[a][b][m][n] = (f32x4){0.f, 0.f, 0.f, 0.f};
        cur = nxt; cA = nA; cB = nB; ++ui;
        if (wr == 1) PG8_BAR;
    }
    PG8_WAIT_V(0);
    PG8_BAR;
#undef PG8_SA
#undef PG8_SB
#undef PG8_STAGE
#undef PG8_LDA
#undef PG8_LDB
#undef PG8_MMA
#undef PG8_WAIT_V
#undef PG8_WAIT_L
#undef PG8_BAR
#undef PG8_SCHED
}
}

constexpr size_t MiB = 1u << 20;
constexpr size_t WS_CTL = 0, CTL_ZERO_BYTES = 1 * MiB;
constexpr size_t WS_WGU = 1 * MiB;
constexpr size_t WS_WD = 257 * MiB;
constexpr size_t WS_WPG = 385 * MiB;
constexpr size_t WS_WPLE = 393 * MiB;
constexpr size_t WS_WR = 394 * MiB;
constexpr size_t WS_CS = 395 * MiB;
constexpr size_t WS_SSQ = 399 * MiB;
constexpr size_t WS_TSS = 400 * MiB;
constexpr size_t WS_ROUTE = 402 * MiB;
constexpr size_t WS_Y = 403 * MiB;
constexpr size_t WS_E = 531 * MiB;
constexpr size_t WS_XB = 595 * MiB;
constexpr size_t WS_PB = 659 * MiB;
constexpr size_t WS_WIN = 667 * MiB;
constexpr size_t WS_WKR = 683 * MiB;
constexpr size_t WS_WUQ = 684 * MiB;
constexpr size_t WS_WKV = WS_WUQ + (size_t)1536 * 512 * 2;
constexpr size_t WS_WO = 688 * MiB;
constexpr size_t WS_QKVNA = 696 * MiB;
constexpr size_t WS_CQKV = 792 * MiB;
constexpr size_t WS_KPE = 824 * MiB;
constexpr size_t WS_Q = 826 * MiB;
constexpr size_t WS_KV = 874 * MiB;
constexpr size_t WS_O = 938 * MiB;
constexpr size_t WS_XS = 696 * MiB;
constexpr size_t WS_H = 888 * MiB;
constexpr size_t WS_YS = 696 * MiB;
constexpr size_t WS_T = 888 * MiB;
constexpr size_t WS_END = 1024 * MiB;
static_assert(WS_O + (size_t)NTOK * DM * 2 <= WS_END && WS_XS + (size_t)MAXP * DM * 2 <= WS_H && WS_H + (size_t)MAXP * DEXP * 2 <= WS_END && WS_T + (size_t)NTOK * DM * 2 <= WS_END, "ws map");
constexpr int CW_BAR = 4096;
constexpr int CW_CNT = 16384;

constexpr int RING_OFF = 0, RING_BYTES = 131072;
constexpr int LDSCTL_OFF = RING_BYTES, MISC_OFF = LDSCTL_OFF + 320;
constexpr int TAB_OFF = MISC_OFF + 128;
constexpr int LDS_BYTES = 147456;
static_assert(TAB_OFF + 4 * (65 + 192 + 8) <= LDS_BYTES, "LDS map");

#define XB_TMO      128
#define XB_XCNT(j)  (256  + 64 * (j))
#define XB_XSUB(j)  (1280 + 64 * (j))
#define XB_XGEN(j)  (2304 + 64 * (j))
#define XB_TOP      3328
#define XB_TOPGEN   3392
#define XCD_BAR_WORDS 3456
#define XB_SPIN_CAP (1u << 22)
__device__ __forceinline__ unsigned xb_ld(unsigned* p)              { return __hip_atomic_load(p, __ATOMIC_RELAXED, __HIP_MEMORY_SCOPE_AGENT); }
__device__ __forceinline__ unsigned xb_add(unsigned* p, unsigned v) { return __hip_atomic_fetch_add(p, v, __ATOMIC_RELAXED, __HIP_MEMORY_SCOPE_AGENT); }
__device__ __forceinline__ unsigned xb_xcc_id() { return (unsigned)__builtin_amdgcn_s_getreg((3 << 11) | 20) & 0xFu; }
#define XB_SPIN(cond, bar) do { unsigned _sp = 0; while (cond) { __builtin_amdgcn_s_sleep(1); \
    if ((++_sp & 255u) == 0u) { if (xb_ld(&(bar)[XB_TMO])) break; if (_sp > XB_SPIN_CAP) { atomicAdd(&(bar)[XB_TMO], 1u); break; } } } } while (0)
struct XcdBarrier { unsigned* bar; unsigned x; volatile LAS unsigned* st; };
__device__ __forceinline__ XcdBarrier xcd_barrier_post(unsigned* bar, volatile LAS unsigned* st) {
    XcdBarrier b; b.bar = bar; b.x = xb_xcc_id(); b.st = st;
    if (threadIdx.x == 0) (void)xb_add(&bar[XB_XCNT(b.x)], 1u);
    return b;
}
__device__ __forceinline__ void xcd_barrier_complete(unsigned* bar, unsigned x, unsigned& nloc, unsigned& nx) {
    const unsigned G = gridDim.x * gridDim.y * gridDim.z;
    unsigned sum, cnt, mine, sp = 0u;
    for (;;) {
        sum = 0u; cnt = 0u; mine = 0u;
#pragma unroll
        for (unsigned j = 0; j < 16; ++j) { const unsigned c = xb_ld(&bar[XB_XCNT(j)]); sum += c; cnt += (c > 0u) ? 1u : 0u; mine = (j == x) ? c : mine; }
        if (sum == G) break;
        __builtin_amdgcn_s_sleep(1);
        if ((++sp & 255u) == 0u) { if (xb_ld(&bar[XB_TMO])) break; if (sp > XB_SPIN_CAP) { atomicAdd(&bar[XB_TMO], 1u); break; } }
    }
    nloc = mine > 0u ? mine : 1u; nx = cnt > 0u ? cnt : 1u;
}
__device__ __forceinline__ void xcd_barrier(const XcdBarrier& b) {
    asm volatile("s_waitcnt vmcnt(0)" ::: "memory");
    __syncthreads();
    if (threadIdx.x == 0) {
        unsigned* bar = b.bar;
        __builtin_amdgcn_s_waitcnt(0);
        unsigned nloc = b.st[0], nx = b.st[1];
        if (nloc == 0u) { xcd_barrier_complete(bar, b.x, nloc, nx); b.st[0] = nloc; b.st[1] = nx; }
        const unsigned old = xb_add(&bar[XB_XSUB(b.x)], 1u);
        const unsigned gen = old / nloc;
        if (old + 1u == (gen + 1u) * nloc) {
            __builtin_amdgcn_fence(__ATOMIC_RELEASE, "agent");
            asm volatile("s_waitcnt vmcnt(0)" ::: "memory");
            const unsigned og = xb_add(&bar[XB_TOP], 1u);
            const unsigned tg = og / nx;
            if (og + 1u == (tg + 1u) * nx) xb_add(&bar[XB_TOPGEN], 1u);
            else XB_SPIN(xb_ld(&bar[XB_TOPGEN]) == tg, bar);
            __builtin_amdgcn_fence(__ATOMIC_ACQUIRE, "agent");
            xb_add(&bar[XB_XGEN(b.x)], 1u);
            asm volatile("s_waitcnt vmcnt(0)" ::: "memory");
        } else {
            XB_SPIN(xb_ld(&bar[XB_XGEN(b.x)]) == gen, bar);
            __builtin_amdgcn_fence(__ATOMIC_ACQUIRE, "agent");
            asm volatile("s_waitcnt vmcnt(0)" ::: "memory");
        }
    }
    __syncthreads();
}

struct Frame {
    LAS unsigned char* lds;
    volatile LAS unsigned* MISC;
    gu32* ctl;
    unsigned char* ws;
    int tid, lane, wave, G, bid;
    const float* in[25];
    float* out;
};
__device__ __forceinline__ float wave_sum(float v) {
#pragma unroll
    for (int o = 1; o < 64; o <<= 1) v += __shfl_xor(v, o);
    return v;
}

__device__ __forceinline__ int lane_id() { return (int)__builtin_amdgcn_mbcnt_hi(~0u, __builtin_amdgcn_mbcnt_lo(~0u, 0u)); }

template <class F>
__device__ __forceinline__ void p0_transpose_item(const float* W, int K, int N, LAS float* scr, int item, int lane, const float* gs, F dstrow) {
    const int nblk = N / 32, kb = item / nblk, nb = item % nblk, k0 = 64 * kb, n0 = 32 * nb;
#pragma unroll 8
    for (int i = 0; i < 32; ++i) { const int kk = 2 * i + (lane >> 5); float v = W[(size_t)(k0 + kk) * N + n0 + (lane & 31)]; if (gs) v *= gs[k0 + kk]; scr[kk * 33 + (lane & 31)] = v; }
    LDS_WAIT(); asm volatile("" ::: "memory");
    const int c = lane & 7;
#pragma unroll
    for (int j = 0; j < 4; ++j) { const int n = (lane >> 3) + 8 * j; const LAS float* s = scr + (8 * c) * 33 + n;
        v4u o; o.x = pk2(s[0 * 33], s[1 * 33]); o.y = pk2(s[2 * 33], s[3 * 33]); o.z = pk2(s[4 * 33], s[5 * 33]); o.w = pk2(s[6 * 33], s[7 * 33]);
        *(GAS v4u*)(dstrow(n0 + n) + k0 + 8 * c) = o; }
    LDS_WAIT(); asm volatile("" ::: "memory");
}
__device__ __forceinline__ int rope_perm(int i) { return i < 32 ? 2 * i : 2 * (i - 32) + 1; }

__device__ __forceinline__ void p0_prologue(Frame& F) {
    LAS float* scr = (LAS float*)(F.lds + RING_OFF + F.wave * 16384);
    const int gw = F.bid * 8 + F.wave, NGW = F.G * 8;
    unsigned char* ws = F.ws;
    bf16* WinT = (bf16*)(ws + WS_WIN); bf16* WkrT = (bf16*)(ws + WS_WKR); bf16* WuqT = (bf16*)(ws + WS_WUQ); bf16* WkvT = (bf16*)(ws + WS_WKV);
    bf16* WoT = (bf16*)(ws + WS_WO); bf16* WpgT = (bf16*)(ws + WS_WPG); bf16* WpleT = (bf16*)(ws + WS_WPLE); bf16* WguT = (bf16*)(ws + WS_WGU); bf16* WdT = (bf16*)(ws + WS_WD);
    constexpr int I_IN = (DM / 64) * (INW / 32), I_UQ = (QLR / 64) * (MH * QKD / 32), I_UK = (KVLR / 64) * (MH * NOPE / 32), I_UV = (KVLR / 64) * (MLAW / 32);
    constexpr int I_O = (DM / 64) * (DM / 32), I_PG = I_O, I_PLE = (PLE / 64) * (DM / 32);
    constexpr int I_G1 = (DM / 64) * (DEXP / 32), I_DN1 = (DEXP / 64) * (DM / 32);
    constexpr int I_SMALL = I_IN + I_UQ + I_UK + I_UV + I_O + I_PG + I_PLE;
    constexpr int NITEMS = I_SMALL + NEXP * (2 * I_G1 + I_DN1);
    for (int it = gw; it < NITEMS; it += NGW) {
        int r = it;
        if (r < I_IN) { p0_transpose_item(F.in[3], DM, INW, scr, r, F.lane, nullptr, [&](int n) { return n < 4096 ? WinT + (size_t)n * DM : WkrT + (size_t)rope_perm(n - 4096) * DM; }); continue; } r -= I_IN;
        if (r < I_UQ) { p0_transpose_item(F.in[7], QLR, MH * QKD, scr, r, F.lane, F.in[5], [&](int n) { const int h = n / QKD, d = n % QKD; const int dd = d < NOPE ? d : NOPE + rope_perm(d - NOPE); return WuqT + (size_t)(h * QKD + dd) * QLR; }); continue; } r -= I_UQ;
        if (r < I_UK) { p0_transpose_item(F.in[8], KVLR, MH * NOPE, scr, r, F.lane, F.in[6], [&](int n) { return WkvT + (size_t)n * KVLR; }); continue; } r -= I_UK;
        if (r < I_UV) { p0_transpose_item(F.in[9], KVLR, MLAW, scr, r, F.lane, F.in[6], [&](int n) { return WkvT + (size_t)(1024 + n) * KVLR; }); continue; } r -= I_UV;
        if (r < I_O) { p0_transpose_item(F.in[10], DM, DM, scr, r, F.lane, nullptr, [&](int n) { return WoT + (size_t)n * DM; }); continue; } r -= I_O;
        if (r < I_PG) { p0_transpose_item(F.in[23], DM, DM, scr, r, F.lane, nullptr, [&](int n) { return WpgT + (size_t)n * DM; }); continue; } r -= I_PG;
        if (r < I_PLE) { p0_transpose_item(F.in[22], PLE, DM, scr, r, F.lane, nullptr, [&](int n) { return WpleT + (size_t)n * PLE; }); continue; } r -= I_PLE;
        const int e = r / (2 * I_G1 + I_DN1); r -= e * (2 * I_G1 + I_DN1);
        bf16* gu = WguT + (size_t)e * 1024 * DM;
        if (r < I_G1) { p0_transpose_item(F.in[17] + (size_t)e * DM * DEXP, DM, DEXP, scr, r, F.lane, nullptr, [&](int n) { return gu + (size_t)(32 * (n >> 4) + (n & 15)) * DM; }); continue; } r -= I_G1;
        if (r < I_G1) { p0_transpose_item(F.in[18] + (size_t)e * DM * DEXP, DM, DEXP, scr, r, F.lane, nullptr, [&](int n) { return gu + (size_t)(32 * (n >> 4) + 16 + (n & 15)) * DM; }); continue; } r -= I_G1;
        bf16* dn = WdT + (size_t)e * DM * DEXP;
        p0_transpose_item(F.in[19] + (size_t)e * DEXP * DM, DEXP, DM, scr, r, F.lane, nullptr, [&](int n) { return dn + (size_t)n * DEXP; });
    }
    const size_t gt = (size_t)F.bid * 512 + F.tid, GT = (size_t)F.G * 512;
    { const GAS f32x4* src = (const GAS f32x4*)F.in[0]; GAS v4u* dst = (GAS v4u*)(ws + WS_XB);
      for (size_t i = gt; i < (size_t)NTOK * DM / 8; i += GT) { const f32x4 a = src[2 * i], b = src[2 * i + 1]; v4u o; o.x = pk2(a.x, a.y); o.y = pk2(a.z, a.w); o.z = pk2(b.x, b.y); o.w = pk2(b.z, b.w); dst[i] = o; } }
    { const GAS f32x4* src = (const GAS f32x4*)F.in[1]; GAS v4u* dst = (GAS v4u*)(ws + WS_PB);
      for (size_t i = gt; i < (size_t)NTOK * PLE / 8; i += GT) { const f32x4 a = src[2 * i], b = src[2 * i + 1]; v4u o; o.x = pk2(a.x, a.y); o.y = pk2(a.z, a.w); o.z = pk2(b.x, b.y); o.w = pk2(b.z, b.w); dst[i] = o; } }
    { const int* pos = (const int*)F.in[2]; f32x2* cs = (f32x2*)(ws + WS_CS);
      for (size_t i = gt; i < (size_t)NTOK * 32; i += GT) { const int t = (int)(i >> 5), j = (int)(i & 31); const float e = (float)(2 * j) / 64.0f; const float invf = 1.0f / powf(10000.0f, e);
          const float ang = (float)pos[t] * invf; cs[i] = (f32x2){cosf(ang), sinf(ang)}; } }
    { bf16* hi = (bf16*)(ws + WS_WR); bf16* lo = hi + 80 * DM; const float* wg = F.in[13]; const float* wr = F.in[15];
      for (size_t i = gt; i < (size_t)80 * DM; i += GT) { const int c = (int)(i / DM), k = (int)(i % DM); const float v = c < 8 ? wg[k * 8 + c] : (c < 72 ? wr[k * 64 + (c - 8)] : 0.f);
          const unsigned h = f2bf(v); hi[i] = (bf16)h; lo[i] = (bf16)f2bf(v - bf2f(h)); } }
}

struct DenseSched {
    const char* A; const char* B; int lda, ldb, nM, nN, G, c;
    __device__ __forceinline__ bool next(int i, pg8::Unit& u) const {
        const long L = (long)i * G + c; if (L >= (long)nM * nN) return false;
        pg8::tile_of((int)L, nM, nN, u.pm, u.pn); u.tag = 0;
        u.A = A + (size_t)u.pm * 256 * lda * 2; u.B = B + (size_t)u.pn * 256 * ldb * 2; return true;
    }
};
struct EpiProj {
    static constexpr bool PERM = true;
    bf16* qkvna; bf16* cqkv; float* ssq;
    __device__ __forceinline__ void operator()(const f32x4 (&acc)[2][2][4][2], const pg8::Unit& u, int wr, int wc, int fr, int fq) const {
        const int row0 = u.pm * 256 + wr * 64 + fr; const bool lat = u.pn >= 12;
        bf16* base = lat ? cqkv : qkvna; const int ldc = lat ? 1024 : 3072; const int col0 = (lat ? (u.pn - 12) : u.pn) * 256 + wc * 32 + 8 * fq;
#pragma unroll
        for (int ai = 0; ai < 2; ++ai)
#pragma unroll
            for (int m = 0; m < 4; ++m) { const int row = row0 + ai * 128 + m * 16; bf16* rowp = base + (size_t)row * ldc + col0; float ss = 0.f;
#pragma unroll
                for (int bj = 0; bj < 2; ++bj) { const f32x4 v0 = acc[ai][bj][m][0], v1 = acc[ai][bj][m][1];
                    v4u w; w.x = cvt_pk_bf16(v0[0], v0[1]); w.y = cvt_pk_bf16(v0[2], v0[3]); w.z = cvt_pk_bf16(v1[0], v1[1]); w.w = cvt_pk_bf16(v1[2], v1[3]);
                    *(v4u*)(rowp + bj * 128) = w;
                    ss += (v0[0] * v0[0] + v0[1] * v0[1]) + (v0[2] * v0[2] + v0[3] * v0[3]) + (v1[0] * v1[0] + v1[1] * v1[1]) + (v1[2] * v1[2] + v1[3] * v1[3]); }
                if (lat) { ss += __shfl_xor(ss, 16); ss += __shfl_xor(ss, 32); if (fq == 0) ssq[(size_t)row * 16 + (u.pn - 12) * 4 + wc] = ss; } }
    }
};
struct SchedUp {
    const char* cqkv; const char* B; int G, c;
    __device__ __forceinline__ bool next(int i, pg8::Unit& u) const {
        const long L = (long)i * G + c; if (L >= 64 * 14) return false;
        pg8::tile_of((int)L, 64, 14, u.pm, u.pn); u.tag = u.pn >= 6;
        u.A = cqkv + (u.pn >= 6 ? 1024 : 0) + (size_t)u.pm * 256 * 1024 * 2; u.B = B + (size_t)u.pn * 256 * 512 * 2; return true;
    }
};
struct EpiUp {
    static constexpr bool PERM = true;
    bf16* q; bf16* kv; const float* ssq; const f32x2* cs;
    __device__ __forceinline__ void operator()(const f32x4 (&acc)[2][2][4][2], const pg8::Unit& u, int wr, int wc, int fr, int fq) const {
        const int row0 = u.pm * 256 + wr * 64 + fr; const bool iskv = u.tag != 0;
        bf16* base = iskv ? kv : q; const int ldc = iskv ? 2048 : 1536; const int col0 = (iskv ? (u.pn - 6) : u.pn) * 256 + wc * 32 + 8 * fq;
#pragma unroll
        for (int ai = 0; ai < 2; ++ai)
#pragma unroll
            for (int m = 0; m < 4; ++m) { const int row = row0 + ai * 128 + m * 16; bf16* rowp = base + (size_t)row * ldc + col0;
                const f32x4 s0 = *(const f32x4*)(ssq + (size_t)row * 16 + (iskv ? 8 : 0)), s1 = *(const f32x4*)(ssq + (size_t)row * 16 + (iskv ? 12 : 4));
                const float tot = ((s0[0] + s0[1]) + (s0[2] + s0[3])) + ((s1[0] + s1[1]) + (s1[2] + s1[3]));
                const float rs = 1.0f / sqrtf(tot * (1.0f / 512.0f) + RMS_EPS);
#pragma unroll
                for (int bj = 0; bj < 2; ++bj) { f32x4 v0 = acc[ai][bj][m][0] * rs, v1 = acc[ai][bj][m][1] * rs;
                    const int col = col0 + bj * 128; const int d = col % QKD;
                    if (!iskv && d >= NOPE) { const f32x2* c4 = cs + (size_t)row * 32 + ((d - NOPE) >> 1);
                        const f32x2 c0 = c4[0], c1 = c4[1], c2 = c4[2], c3 = c4[3];
                        v0 = (f32x4){v0[0] * c0.x - v0[1] * c0.y, v0[0] * c0.y + v0[1] * c0.x, v0[2] * c1.x - v0[3] * c1.y, v0[2] * c1.y + v0[3] * c1.x};
                        v1 = (f32x4){v1[0] * c2.x - v1[1] * c2.y, v1[0] * c2.y + v1[1] * c2.x, v1[2] * c3.x - v1[3] * c3.y, v1[2] * c3.y + v1[3] * c3.x}; }
                    v4u w; w.x = cvt_pk_bf16(v0[0], v0[1]); w.y = cvt_pk_bf16(v0[2], v0[3]); w.z = cvt_pk_bf16(v1[0], v1[1]); w.w = cvt_pk_bf16(v1[2], v1[3]);
                    *(v4u*)(rowp + bj * 128) = w; } }
    }
};
struct EpiBf16 {
    static constexpr bool PERM = true;
    bf16* O; int ldc;
    __device__ __forceinline__ void operator()(const f32x4 (&acc)[2][2][4][2], const pg8::Unit& u, int wr, int wc, int fr, int fq) const {
        const int row0 = u.pm * 256 + wr * 64 + fr; const int col0 = u.pn * 256 + wc * 32 + 8 * fq;
#pragma unroll
        for (int ai = 0; ai < 2; ++ai)
#pragma unroll
            for (int m = 0; m < 4; ++m) { bf16* rowp = O + (size_t)(row0 + ai * 128 + m * 16) * ldc + col0;
#pragma unroll
                for (int bj = 0; bj < 2; ++bj) { const f32x4 v0 = acc[ai][bj][m][0], v1 = acc[ai][bj][m][1];
                    v4u w; w.x = cvt_pk_bf16(v0[0], v0[1]); w.y = cvt_pk_bf16(v0[2], v0[3]); w.z = cvt_pk_bf16(v1[0], v1[1]); w.w = cvt_pk_bf16(v1[2], v1[3]);
                    *(v4u*)(rowp + bj * 128) = w; } }
    }
};
struct EpiWo {
    static constexpr bool PERM = false;
    const float* x; float* y;
    __device__ __forceinline__ void operator()(const f32x4 (&acc)[2][2][4][2], const pg8::Unit& u, int wr, int wc, int fr, int fq) const {
        const int row0 = u.pm * 256 + wr * 64 + fr, col0 = u.pn * 256 + wc * 32 + 4 * fq;
#pragma unroll
        for (int ai = 0; ai < 2; ++ai)
#pragma unroll
            for (int m = 0; m < 4; ++m) { const size_t off = (size_t)(row0 + ai * 128 + m * 16) * DM + col0;
#pragma unroll
                for (int bj = 0; bj < 2; ++bj)
#pragma unroll
                    for (int n = 0; n < 2; ++n) { const f32x4 xv = *(const f32x4*)(x + off + bj * 128 + n * 16); *(f32x4*)(y + off + bj * 128 + n * 16) = xv * ALPHA + acc[ai][bj][m][n]; }
                asm volatile("" ::: "memory"); }
    }
};
struct SchedMoe {
    const char* A; const char* W; const LAS int* tile_expert; int lda, nT, nN; size_t wstride  ; int ldb, G, c;
    __device__ __forceinline__ bool next(int i, pg8::Unit& u) const {
        const long L = (long)i * G + c; if (L >= (long)nT * nN) return false;
        u.pm = (int)(L / nN); u.pn = (int)(L % nN); u.tag = tile_expert[u.pm];
        u.A = A + (size_t)u.pm * 256 * lda * 2; u.B = W + (size_t)u.tag * wstride + (size_t)u.pn * 256 * ldb * 2; return true;
    }
};
struct EpiGateUp {
    static constexpr bool PERM = false;
    bf16* H;
    __device__ __forceinline__ void operator()(const f32x4 (&acc)[2][2][4][2], const pg8::Unit& u, int wr, int wc, int fr, int fq) const {
        const int row0 = u.pm * 256 + wr * 64 + fr;
#pragma unroll
        for (int ai = 0; ai < 2; ++ai)
#pragma unroll
            for (int m = 0; m < 4; ++m) { bf16* rowp = H + (size_t)(row0 + ai * 128 + m * 16) * DEXP;
#pragma unroll
                for (int bj = 0; bj < 2; ++bj) { const f32x4 g = acc[ai][bj][m][0], up = acc[ai][bj][m][1]; f32x4 h;
#pragma unroll
                    for (int j = 0; j < 4; ++j) h[j] = g[j] / (1.0f + __expf(-g[j])) * up[j];
                    const int hc = 16 * (8 * u.pn + 4 * bj + wc) + 4 * fq;
                    v2u w; w.x = cvt_pk_bf16(h[0], h[1]); w.y = cvt_pk_bf16(h[2], h[3]); *(v2u*)(rowp + hc) = w; } }
    }
};
struct EpiPle {
    static constexpr bool PERM = true;
    const bf16* E; bf16* T; float* tss;
    __device__ __forceinline__ void operator()(const f32x4 (&acc)[2][2][4][2], const pg8::Unit& u, int wr, int wc, int fr, int fq) const {
        const int row0 = u.pm * 256 + wr * 64 + fr; const int col0 = u.pn * 256 + wc * 32 + 8 * fq;
#pragma unroll
        for (int ai = 0; ai < 2; ++ai)
#pragma unroll
            for (int m = 0; m < 4; ++m) { const int row = row0 + ai * 128 + m * 16; const size_t off = (size_t)row * DM + col0; float ss = 0.f;
#pragma unroll
                for (int bj = 0; bj < 2; ++bj) { const v4u ev = *(const v4u*)(E + off + bj * 128); const f32x4 v0 = acc[ai][bj][m][0], v1 = acc[ai][bj][m][1]; float t[8];
#pragma unroll
                    for (int j = 0; j < 4; ++j) { const unsigned ew = ev[j]; const float e0 = bf2f(ew & 0xffffu), e1 = bf2f(ew >> 16);
                        const float g0 = j < 2 ? v0[2 * j] : v1[2 * j - 4], g1 = j < 2 ? v0[2 * j + 1] : v1[2 * j - 3];
                        t[2 * j] = e0 / (1.0f + __expf(-g0)); t[2 * j + 1] = e1 / (1.0f + __expf(-g1)); }
                    v4u w; w.x = cvt_pk_bf16(t[0], t[1]); w.y = cvt_pk_bf16(t[2], t[3]); w.z = cvt_pk_bf16(t[4], t[5]); w.w = cvt_pk_bf16(t[6], t[7]);
                    *(v4u*)(T + off + bj * 128) = w;
#pragma unroll
                    for (int j = 0; j < 8; ++j) ss += t[j] * t[j]; }
                ss += __shfl_xor(ss, 16); ss += __shfl_xor(ss, 32); if (fq == 0) tss[(size_t)row * 32 + u.pn * 4 + wc] = ss; }
    }
};

namespace mla {
constexpr int KVBLK = 64, QBLK = 32;
constexpr float SCALE = 0.07216878364870322f;
constexpr float THR = 8.f;
constexpr int SHM_V = 16384, SHM_KN = 16384, SHM_KP = 8192;
constexpr int OFF_V = 0, OFF_KN = 2 * SHM_V, OFF_KP = OFF_KN + 2 * SHM_KN, OFF_WS = OFF_KP + 2 * SHM_KP, OFF_QP = OFF_WS + 8 * 64 * 4, LDS_TOTAL = OFF_QP + 8 * 4096;
#define KSWZ(row, colB) ((row) * 256 + ((colB) ^ (((row) & 7) << 4)))
#define KPSWZ(row, colB) ((row) * 128 + ((colB) ^ ((((row) >> 1) & 7) << 4)))
__device__ __forceinline__ int crow(int r, int hi) { return (r & 3) + 8 * (r >> 2) + 4 * hi; }
__device__ __forceinline__ void partialSM(f32x16& p0, f32x16& p1, float& m_reg, float& mn, float& alpha) {
  constexpr float C = SCALE * 1.4426950408889634f;
  float pmax = p0[0];
#pragma unroll
  for (int r = 1; r < 16; ++r) pmax = fmaxf(pmax, p0[r]);
#pragma unroll
  for (int r = 0; r < 16; ++r) pmax = fmaxf(pmax, p1[r]);
  { auto rr = __builtin_amdgcn_permlane32_swap(__float_as_uint(pmax), __float_as_uint(pmax), false, false);
    pmax = fmaxf(__uint_as_float(rr[0]), __uint_as_float(rr[1])); }
  if (__builtin_expect(__all(pmax - m_reg <= THR / SCALE), 1)) { mn = m_reg; alpha = 1.f; }
  else { mn = fmaxf(m_reg, pmax); alpha = __builtin_amdgcn_exp2f((m_reg - mn) * C); m_reg = mn; }
  float mnC = -mn * C;
#pragma unroll
  for (int r = 0; r < 16; ++r) p0[r] = fmaf(p0[r], C, mnC);
#pragma unroll
  for (int r = 0; r < 16; ++r) p1[r] = fmaf(p1[r], C, mnC);
#pragma unroll
  for (int r = 0; r < 16; ++r) p0[r] = __builtin_amdgcn_exp2f(p0[r]);
}
__device__ __forceinline__ void finishSM(f32x16& p0, f32x16& p1, float alpha, float& l_reg, bf16x8& pa0, bf16x8& pa1, bf16x8& pa2, bf16x8& pa3) {
#pragma unroll
  for (int r = 0; r < 16; ++r) p1[r] = __builtin_amdgcn_exp2f(p1[r]);
  float ps = 0;
#pragma unroll
  for (int r = 0; r < 16; ++r) ps += p0[r];
#pragma unroll
  for (int r = 0; r < 16; ++r) ps += p1[r];
  { auto rr = __builtin_amdgcn_permlane32_swap(__float_as_uint(ps), __float_as_uint(ps), false, false);
    ps = __uint_as_float(rr[0]) + __uint_as_float(rr[1]); }
  l_reg = l_reg * alpha + ps;
#define PK4(P, BASE, OUT) do { unsigned a0 = cvt_pk_bf16(P[BASE + 0], P[BASE + 1]), a1 = cvt_pk_bf16(P[BASE + 2], P[BASE + 3]);   \
    unsigned b0 = cvt_pk_bf16(P[BASE + 4], P[BASE + 5]), b1 = cvt_pk_bf16(P[BASE + 6], P[BASE + 7]);                              \
    auto r0 = __builtin_amdgcn_permlane32_swap(a0, b0, false, false); auto r1 = __builtin_amdgcn_permlane32_swap(a1, b1, false, false); \
    v4u w = {r0[0], r1[0], r0[1], r1[1]}; OUT = *reinterpret_cast<bf16x8*>(&w); } while (0)
  PK4(p0, 0, pa0); PK4(p0, 8, pa1); PK4(p1, 0, pa2); PK4(p1, 8, pa3);
#undef PK4
}
__device__ __forceinline__ void qkt(f32x16& p0, f32x16& p1, const char* Kn, const char* Kp, const bf16x8* qr, const char* qp, int r32, int hi) {
  p0 = f32x16{}; p1 = f32x16{};
#pragma unroll
  for (int d0 = 0; d0 < 8; ++d0) { const int cb = (d0 * 16 + hi * 8) * 2;
    bf16x8 b0 = *reinterpret_cast<const bf16x8*>(Kn + KSWZ(r32, cb));
    bf16x8 b1 = *reinterpret_cast<const bf16x8*>(Kn + KSWZ(32 + r32, cb));
    p0 = __builtin_amdgcn_mfma_f32_32x32x16_bf16(b0, qr[d0], p0, 0, 0, 0);
    p1 = __builtin_amdgcn_mfma_f32_32x32x16_bf16(b1, qr[d0], p1, 0, 0, 0); }
#pragma unroll
  for (int d0 = 0; d0 < 4; ++d0) { const int cb = (d0 * 16 + hi * 8) * 2;
    bf16x8 b0 = *reinterpret_cast<const bf16x8*>(Kp + KPSWZ(r32, cb));
    bf16x8 b1 = *reinterpret_cast<const bf16x8*>(Kp + KPSWZ(32 + r32, cb));
    const bf16x8 qv = *reinterpret_cast<const bf16x8*>(qp + d0 * 1024);
    p0 = __builtin_amdgcn_mfma_f32_32x32x16_bf16(b0, qv, p0, 0, 0, 0);
    p1 = __builtin_amdgcn_mfma_f32_32x32x16_bf16(b1, qv, p1, 0, 0, 0); }
}
__device__ __forceinline__ int v_st(int k, int c) { const int kk = (k & ~0xC) | ((k & 4) << 1) | ((k & 8) >> 1); return ((kk >> 3) * 4 + (c >> 5)) * 512 + ((kk & 7) * 32 + (c & 31)) * 2; }
__device__ __forceinline__ int v_rd_base(int lane) { return ((lane & 3) << 3) | (((lane >> 2) & 3) << 6) | (((lane >> 4) & 1) << 5) | (((lane >> 5) & 1) << 8); }
constexpr int v_rd_off(int d0, int ks, int half) { return d0 * 512 + ks * 4096 + half * 2048; }
template <int OFF> __device__ __forceinline__ s16x4 tr_read(int vb) {
  s16x4 r; asm volatile("ds_read_b64_tr_b16 %0, %1 offset:%2" : "=&v"(r) : "v"(vb), "i"(OFF) : "memory"); return r;
}
template <int D0> __device__ __forceinline__ void pv_one(f32x16& od, int vb, bf16x8 pa0, bf16x8 pa1, bf16x8 pa2, bf16x8 pa3) {
  const s16x4 l0 = tr_read<v_rd_off(D0, 0, 0)>(vb), h0 = tr_read<v_rd_off(D0, 0, 1)>(vb), l1 = tr_read<v_rd_off(D0, 1, 0)>(vb), h1 = tr_read<v_rd_off(D0, 1, 1)>(vb);
  const s16x4 l2 = tr_read<v_rd_off(D0, 2, 0)>(vb), h2 = tr_read<v_rd_off(D0, 2, 1)>(vb), l3 = tr_read<v_rd_off(D0, 3, 0)>(vb), h3 = tr_read<v_rd_off(D0, 3, 1)>(vb);
  asm volatile("s_waitcnt lgkmcnt(0)" ::: "memory"); SBAR();
#define PK(L, H) (bf16x8){L[0], L[1], L[2], L[3], H[0], H[1], H[2], H[3]}
  od = __builtin_amdgcn_mfma_f32_32x32x16_bf16(pa0, PK(l0, h0), od, 0, 0, 0);
  od = __builtin_amdgcn_mfma_f32_32x32x16_bf16(pa1, PK(l1, h1), od, 0, 0, 0);
  od = __builtin_amdgcn_mfma_f32_32x32x16_bf16(pa2, PK(l2, h2), od, 0, 0, 0);
  od = __builtin_amdgcn_mfma_f32_32x32x16_bf16(pa3, PK(l3, h3), od, 0, 0, 0);
#undef PK
}
__device__ __forceinline__ void pv_d0(f32x16* o, int vb, bf16x8 pa0, bf16x8 pa1, bf16x8 pa2, bf16x8 pa3) {
  pv_one<0>(o[0], vb, pa0, pa1, pa2, pa3); pv_one<1>(o[1], vb, pa0, pa1, pa2, pa3); pv_one<2>(o[2], vb, pa0, pa1, pa2, pa3); pv_one<3>(o[3], vb, pa0, pa1, pa2, pa3);
}
__device__ __forceinline__ void attn_unit(const bf16* __restrict__ Qb, const bf16* __restrict__ Kn, const bf16* __restrict__ Kp, const bf16* __restrict__ Vh, bf16* __restrict__ Ob, int seq, char* lds) {
  constexpr int LDQ = 1536, LDK = 2048, LDP = 64, LDO = 2048;
  const int tid = threadIdx.x, wid = tid >> 6, lane = tid & 63, r32 = lane & 31, hi = lane >> 5;
  char* V_lds = lds + OFF_V; char* KN_lds = lds + OFF_KN; char* KP_lds = lds + OFF_KP;
  float* ws = (float*)(lds + OFF_WS) + wid * 64; float* li_l = ws; float* al_l = ws + 32;
  float m_reg = -1e30f, l_reg = 0; f32x16 o[4] = {}; bf16x8 qr[8];
  const bf16* Qw = Qb + (long)(wid * QBLK + r32) * LDQ + hi * 8;
  char* qp = lds + OFF_QP + wid * 4096 + lane * 16;
#pragma unroll
  for (int d0 = 0; d0 < 8; ++d0) qr[d0] = *reinterpret_cast<const bf16x8*>(Qw + d0 * 16);
#pragma unroll
  for (int d0 = 0; d0 < 4; ++d0) *reinterpret_cast<bf16x8*>(qp + d0 * 1024) = *reinterpret_cast<const bf16x8*>(Qw + 128 + d0 * 16);
  const int sr = tid >> 4, sc = (tid & 15) * 8, vst0 = v_st(sr, sc), vst1 = v_st(32 + sr, sc);
  const int pr = tid >> 3, pc = (tid & 7) * 8;
  const int vb0 = (int)(uintptr_t)V_lds + v_rd_base(lane);
  bf16x8 vs0, vs1, ks0, ks1, kp0;
  const unsigned voff_kv = (unsigned)(sr * LDK + sc) * 2u, voff_kp = (unsigned)(pr * LDP + pc) * 2u;
#define SLOAD(k0) do { const char* vt = (const char*)Vh + (size_t)(k0) * (LDK * 2); const char* kt = (const char*)Kn + (size_t)(k0) * (LDK * 2); const char* pt = (const char*)Kp + (size_t)(k0) * (LDP * 2); \
    vs0 = *reinterpret_cast<const bf16x8*>(vt + voff_kv); vs1 = *reinterpret_cast<const bf16x8*>(vt + 32 * LDK * 2 + voff_kv); \
    ks0 = *reinterpret_cast<const bf16x8*>(kt + voff_kv); ks1 = *reinterpret_cast<const bf16x8*>(kt + 32 * LDK * 2 + voff_kv); \
    kp0 = *reinterpret_cast<const bf16x8*>(pt + voff_kp); } while (0)
#define SWRITE(b) do { *(bf16x8*)(V_lds + (b) * SHM_V + vst0) = vs0; *(bf16x8*)(V_lds + (b) * SHM_V + vst1) = vs1; const int kc = sc * 2; \
    *(bf16x8*)(KN_lds + (b) * SHM_KN + KSWZ(sr, kc)) = ks0; *(bf16x8*)(KN_lds + (b) * SHM_KN + KSWZ(32 + sr, kc)) = ks1; \
    *(bf16x8*)(KP_lds + (b) * SHM_KP + KPSWZ(pr, pc * 2)) = kp0; } while (0)
#define SWAIT() asm volatile("s_waitcnt vmcnt(0)" ::: "memory")
#define RESC(a) do { if (__any((a) < 1.f)) { if (hi == 0) al_l[r32] = (a); asm volatile("s_waitcnt lgkmcnt(0)" ::: "memory"); \
    _Pragma("unroll") for (int d = 0; d < 4; ++d) _Pragma("unroll") for (int r = 0; r < 16; ++r) o[d][r] *= al_l[crow(r, hi)]; } } while (0)
  f32x16 pA0, pA1, pB0, pB1; float mnA, mnB, alA, alB; bf16x8 pa0, pa1, pa2, pa3; const int NT = seq / KVBLK;
  SLOAD(0); SWAIT(); SWRITE(0); __syncthreads();
  qkt(pA0, pA1, KN_lds, KP_lds, qr, qp, r32, hi); partialSM(pA0, pA1, m_reg, mnA, alA);
  SLOAD(KVBLK);
  SWAIT(); SWRITE(1); __syncthreads();
  for (int j = 1; j + 1 < NT; j += 2) {
    SBAR(); qkt(pB0, pB1, KN_lds + SHM_KN, KP_lds + SHM_KP, qr, qp, r32, hi);
    finishSM(pA0, pA1, alA, l_reg, pa0, pa1, pa2, pa3); SBAR();
    SLOAD((j + 1) * KVBLK); SBAR();
    pv_d0(o, vb0, pa0, pa1, pa2, pa3); partialSM(pB0, pB1, m_reg, mnB, alB);
    __syncthreads(); SWAIT(); SWRITE(0);
    RESC(alB); __syncthreads();
    SBAR(); qkt(pA0, pA1, KN_lds, KP_lds, qr, qp, r32, hi);
    finishSM(pB0, pB1, alB, l_reg, pa0, pa1, pa2, pa3); SBAR();
    SLOAD((j + 2) * KVBLK); SBAR();
    pv_d0(o, vb0 + SHM_V, pa0, pa1, pa2, pa3); partialSM(pA0, pA1, m_reg, mnA, alA);
    __syncthreads(); SWAIT(); SWRITE(1);
    RESC(alA); __syncthreads();
  }
  SBAR(); qkt(pB0, pB1, KN_lds + SHM_KN, KP_lds + SHM_KP, qr, qp, r32, hi);
  finishSM(pA0, pA1, alA, l_reg, pa0, pa1, pa2, pa3); SBAR();
  pv_d0(o, vb0, pa0, pa1, pa2, pa3); partialSM(pB0, pB1, m_reg, mnB, alB);
  __syncthreads(); RESC(alB);
  finishSM(pB0, pB1, alB, l_reg, pa0, pa1, pa2, pa3); SBAR();
  pv_d0(o, vb0 + SHM_V, pa0, pa1, pa2, pa3);
  if (hi == 0) li_l[r32] = l_reg; asm volatile("s_waitcnt lgkmcnt(0)" ::: "memory");
  float rli[16];
#pragma unroll
  for (int r = 0; r < 16; ++r) rli[r] = __builtin_amdgcn_rcpf(li_l[crow(r, hi)]);
  bf16* Ow = Ob + (long)(wid * QBLK) * LDO;
#pragma unroll
  for (int r = 0; r < 16; ++r) { const int orow = crow(r, hi);
#pragma unroll
    for (int d0 = 0; d0 < 4; ++d0) Ow[(long)orow * LDO + d0 * 32 + r32] = (bf16)f2bf(o[d0][r] * rli[r]); }
  __syncthreads();
#undef SLOAD
#undef SWRITE
#undef SWAIT
#undef RESC
}
}

namespace na {
constexpr int KROW = 272, VROW = 288;
constexpr int OFF_K = 0, OFF_V = 64 * KROW, OFF_RPB = OFF_V + 64 * VROW, LDS_TOTAL = OFF_RPB + 2048;
constexpr float SCALE = 0.08838834764831845f, LOG2E = 1.4426950408889634f;
__device__ __forceinline__ s16x4 vtr(const LAS char* p) { typedef short v4i16_t __attribute__((ext_vector_type(4))); return __builtin_bit_cast(s16x4, __builtin_amdgcn_ds_read_tr16_b64_v4i16((LAS v4i16_t*)p)); }
__device__ __forceinline__ void na_unit(int b, int h, int rp, const bf16* __restrict__ qkv, const float* __restrict__ rpb, bf16* __restrict__ O, LAS char* lds) {
    const int tid = threadIdx.x, wid = __builtin_amdgcn_readfirstlane(tid >> 6), lane = tid & 63, qi = lane & 15, G = lane >> 4;
    const int g = wid & 3, rr = 2 * rp + (wid >> 2);
    const int csg = (g == 0) ? 0 : (g == 1) ? 8 : (g == 2) ? 24 : 32;
    const int qc = 16 * g + qi; const int c0 = min(max(qc - 8, 0), 48);
    const int kr0 = min(max(rr - 4, 0), 56);
    const int krA = min(max(2 * rp - 4, 0), 56), krB = min(max(2 * rp + 1 - 4, 0), 56) + 8;
    LAS float* rpb_l = (LAS float*)(lds + OFF_RPB);
    for (int i = tid; i < 15 * 31; i += 512) rpb_l[i] = rpb[h * 465 + i];
    const size_t tokq = (size_t)b * SEQ + rr * 64 + qc;
    bf16x8 qf[4];
#pragma unroll
    for (int ds = 0; ds < 4; ++ds) qf[ds] = *(const bf16x8*)(qkv + tokq * 3072 + h * 128 + 32 * ds + 8 * G);
    const int sr = tid >> 4, sc = (tid & 15) * 8;
    bf16x8 k0, k1, v0, v1;
#define NA_LOAD(kr) do { const bf16* base = qkv + ((size_t)b * SEQ + (kr) * 64) * 3072 + h * 128 + sc; \
        k0 = *(const bf16x8*)(base + (size_t)sr * 3072 + 1024); k1 = *(const bf16x8*)(base + (size_t)(sr + 32) * 3072 + 1024); \
        v0 = *(const bf16x8*)(base + (size_t)sr * 3072 + 2048); v1 = *(const bf16x8*)(base + (size_t)(sr + 32) * 3072 + 2048); } while (0)
    f32x4 ot[8];
#pragma unroll
    for (int d = 0; d < 8; ++d) ot[d] = (f32x4){0.f, 0.f, 0.f, 0.f};
    float m_run = -1e30f, l_run = 0.f;
    NA_LOAD(krA);
    for (int kr = krA; kr < krB; ++kr) {
        __syncthreads();
        *(LAS bf16x8*)(lds + OFF_K + sr * KROW + sc * 2) = k0; *(LAS bf16x8*)(lds + OFF_K + (sr + 32) * KROW + sc * 2) = k1;
        *(LAS bf16x8*)(lds + OFF_V + sr * VROW + sc * 2) = v0; *(LAS bf16x8*)(lds + OFF_V + (sr + 32) * VROW + sc * 2) = v1;
        __syncthreads();
        if (kr + 1 < krB) NA_LOAD(kr + 1);
        if (kr >= kr0 && kr < kr0 + 8) {
            f32x4 st[2] = {(f32x4){0.f, 0.f, 0.f, 0.f}, (f32x4){0.f, 0.f, 0.f, 0.f}};
#pragma unroll
            for (int t = 0; t < 2; ++t)
#pragma unroll
                for (int ds = 0; ds < 4; ++ds) { const bf16x8 kf = *(const LAS bf16x8*)(lds + OFF_K + (csg + 16 * t + qi) * KROW + (32 * ds + 8 * G) * 2);
                    st[t] = __builtin_amdgcn_mfma_f32_16x16x32_bf16(kf, qf[ds], st[t], 0, 0, 0); }
            const LAS float* brow = rpb_l + (kr - rr + 7) * 31;
            float s[8]; float mx = -1e30f;
#pragma unroll
            for (int t = 0; t < 2; ++t)
#pragma unroll
                for (int r = 0; r < 4; ++r) { const int kc = csg + 16 * t + 4 * G + r; const bool ok = (kc >= c0) && (kc < c0 + 16); const int bi = ok ? (kc - qc + 15) : 0;
                    const float v = ok ? (st[t][r] * SCALE + brow[bi]) : -1e30f; s[4 * t + r] = v; mx = fmaxf(mx, v); }
            mx = fmaxf(mx, __shfl_xor(mx, 16)); mx = fmaxf(mx, __shfl_xor(mx, 32));
            const float m_new = fmaxf(m_run, mx); const float alpha = __builtin_amdgcn_exp2f((m_run - m_new) * LOG2E); m_run = m_new;
            float ps = 0.f; float p[8];
#pragma unroll
            for (int i = 0; i < 8; ++i) { p[i] = (s[i] > -1e29f) ? __builtin_amdgcn_exp2f((s[i] - m_new) * LOG2E) : 0.f; ps += p[i]; }
            l_run = l_run * alpha + ps;
            v4u pw; pw.x = cvt_pk_bf16(p[0], p[1]); pw.y = cvt_pk_bf16(p[2], p[3]); pw.z = cvt_pk_bf16(p[4], p[5]); pw.w = cvt_pk_bf16(p[6], p[7]);
            const bf16x8 pf = __builtin_bit_cast(bf16x8, pw);
            const LAS char* vb = lds + OFF_V + (csg + 4 * G + (qi >> 2)) * VROW + (4 * (qi & 3)) * 2;
#pragma unroll
            for (int dt = 0; dt < 8; ++dt) { const s16x4 lo = vtr(vb + dt * 32), hi = vtr(vb + 16 * VROW + dt * 32);
                const bf16x8 vf = (bf16x8){lo[0], lo[1], lo[2], lo[3], hi[0], hi[1], hi[2], hi[3]};
                ot[dt] = ot[dt] * alpha;
                ot[dt] = __builtin_amdgcn_mfma_f32_16x16x32_bf16(vf, pf, ot[dt], 0, 0, 0); }
        }
    }
    l_run += __shfl_xor(l_run, 16); l_run += __shfl_xor(l_run, 32);
    const float rl = 1.0f / l_run;
    bf16* orow = O + tokq * 2048 + h * 128 + 4 * G;
#pragma unroll
    for (int dt = 0; dt < 8; ++dt) { v2u w; w.x = cvt_pk_bf16(ot[dt][0] * rl, ot[dt][1] * rl); w.y = cvt_pk_bf16(ot[dt][2] * rl, ot[dt][3] * rl); *(v2u*)(orow + 16 * dt) = w; }
    __syncthreads();
#undef NA_LOAD
}
}

__device__ __forceinline__ void p1_kr(Frame& F) {
    const bf16* xb = (const bf16*)(F.ws + WS_XB); const bf16* W = (const bf16*)(F.ws + WS_WKR); const f32x2* cs = (const f32x2*)(F.ws + WS_CS); bf16* kpe = (bf16*)(F.ws + WS_KPE);
    const int rg = F.wave & 3, ch = F.wave >> 2, fr = F.lane & 15, fq = F.lane >> 4;
    for (int rb = F.bid; rb < NTOK / 64; rb += F.G) {
        const int row = rb * 64 + rg * 16 + fr;
        const bf16* xa = xb + (size_t)row * DM + 8 * fq;
        const bf16* w0 = W + (size_t)(ch * 32 + fr) * DM + 8 * fq; const bf16* w1 = w0 + 16 * DM;
        f32x4 a0 = {0.f, 0.f, 0.f, 0.f}, a1 = {0.f, 0.f, 0.f, 0.f};
#pragma unroll 8
        for (int ks = 0; ks < DM / 32; ++ks) { const bf16x8 xv = *(const bf16x8*)(xa + ks * 32), b0 = *(const bf16x8*)(w0 + ks * 32), b1 = *(const bf16x8*)(w1 + ks * 32);
            a0 = __builtin_amdgcn_mfma_f32_16x16x32_bf16(b0, xv, a0, 0, 0, 0); a1 = __builtin_amdgcn_mfma_f32_16x16x32_bf16(b1, xv, a1, 0, 0, 0); }
#pragma unroll
        for (int t = 0; t < 2; ++t) { const f32x4 a = t ? a1 : a0; const int col = 32 * ch + 16 * t + 4 * fq; const f32x2 c0 = cs[(size_t)row * 32 + (col >> 1)], c1 = cs[(size_t)row * 32 + (col >> 1) + 1];
            v2u w; w.x = cvt_pk_bf16(a[0] * c0.x - a[1] * c0.y, a[0] * c0.y + a[1] * c0.x); w.y = cvt_pk_bf16(a[2] * c1.x - a[3] * c1.y, a[2] * c1.y + a[3] * c1.x);
            *(v2u*)(kpe + (size_t)row * 64 + col) = w; }
    }
}

__device__ __forceinline__ void ln_row(f32x4 (&v)[8], const float* g, const float* bta, int lane) {
    float s = 0.f;
#pragma unroll
    for (int j = 0; j < 8; ++j) s += (v[j].x + v[j].y) + (v[j].z + v[j].w);
    const float mean = wave_sum(s) * (1.f / DM); float s2 = 0.f;
#pragma unroll
    for (int j = 0; j < 8; ++j) { v[j] = v[j] - mean; s2 += (v[j].x * v[j].x + v[j].y * v[j].y) + (v[j].z * v[j].z + v[j].w * v[j].w); }
    const float rstd = 1.f / sqrtf(wave_sum(s2) * (1.f / DM) + LN_EPS);
#pragma unroll
    for (int j = 0; j < 8; ++j) { const f32x4 gg = *(const f32x4*)(g + 4 * lane + 256 * j), bb = *(const f32x4*)(bta + 4 * lane + 256 * j); v[j] = v[j] * rstd * gg + bb; }
}
__device__ __forceinline__ void store_row_f32_bf16(const f32x4 (&v)[8], float* yrow, bf16* brow, int lane) {
#pragma unroll
    for (int j = 0; j < 8; ++j) { *(f32x4*)(yrow + 4 * lane + 256 * j) = v[j]; v2u w; w.x = pk2(v[j].x, v[j].y); w.y = pk2(v[j].z, v[j].w); *(v2u*)(brow + 4 * lane + 256 * j) = w; }
}

__device__ __forceinline__ void p5_ln_router(Frame& F) {
    float* y = (float*)(F.ws + WS_Y); bf16* x1b = (bf16*)(F.ws + WS_XB);
    const bf16* Whi = (const bf16*)(F.ws + WS_WR); const bf16* Wlo = Whi + 80 * DM;
    int* route = (int*)(F.ws + WS_ROUTE); float* gates = (float*)(F.ws + WS_ROUTE + 256 * 1024);
    unsigned* cnt = (unsigned*)(F.ctl + CW_CNT);
    LAS float* part = (LAS float*)(F.lds + RING_OFF);
    const int fr = F.lane & 15, fq = F.lane >> 4, rg = F.wave & 3, kh = F.wave >> 2;
    for (int rb = F.bid; rb < NTOK / 64; rb += F.G) {
        for (int i = 0; i < 8; ++i) { const int row = rb * 64 + F.wave * 8 + i; float* yr = y + (size_t)row * DM; f32x4 v[8];
#pragma unroll
            for (int j = 0; j < 8; ++j) v[j] = *(const f32x4*)(yr + 4 * F.lane + 256 * j);
            ln_row(v, F.in[11], F.in[12], F.lane); store_row_f32_bf16(v, yr, x1b + (size_t)row * DM, F.lane); }
        VM_WAIT(); __syncthreads();
        if (F.tid == 0) { __builtin_amdgcn_fence(__ATOMIC_ACQUIRE, "agent"); VM_WAIT(); }
        __syncthreads();
        { const int row = rb * 64 + rg * 16 + fr; const float* xa = y + (size_t)row * DM + kh * 1024 + 8 * fq;
          const bf16* wh = Whi + (size_t)fr * DM + kh * 1024 + 8 * fq; const bf16* wl = Wlo + (size_t)fr * DM + kh * 1024 + 8 * fq;
          f32x4 acc[5];
#pragma unroll
          for (int t = 0; t < 5; ++t) acc[t] = (f32x4){0.f, 0.f, 0.f, 0.f};
#pragma unroll 2
          for (int ks = 0; ks < 32; ++ks) { const f32x4 xa0 = *(const f32x4*)(xa + ks * 32), xa1 = *(const f32x4*)(xa + ks * 32 + 4);
              float xv[8] = {xa0.x, xa0.y, xa0.z, xa0.w, xa1.x, xa1.y, xa1.z, xa1.w}; v4u hw, lw;
#pragma unroll
              for (int j = 0; j < 4; ++j) { const unsigned h0 = f2bf(xv[2 * j]), h1 = f2bf(xv[2 * j + 1]); hw[j] = h0 | (h1 << 16); lw[j] = pk2(xv[2 * j] - bf2f(h0), xv[2 * j + 1] - bf2f(h1)); }
              const bf16x8 xh = __builtin_bit_cast(bf16x8, hw), xl = __builtin_bit_cast(bf16x8, lw);
#pragma unroll
              for (int t = 0; t < 5; ++t) { const bf16x8 bh = *(const bf16x8*)(wh + (size_t)t * 16 * DM + ks * 32), bl = *(const bf16x8*)(wl + (size_t)t * 16 * DM + ks * 32);
                  acc[t] = __builtin_amdgcn_mfma_f32_16x16x32_bf16(bh, xh, acc[t], 0, 0, 0);
                  acc[t] = __builtin_amdgcn_mfma_f32_16x16x32_bf16(bh, xl, acc[t], 0, 0, 0);
                  acc[t] = __builtin_amdgcn_mfma_f32_16x16x32_bf16(bl, xh, acc[t], 0, 0, 0); } }
#pragma unroll
          for (int t = 0; t < 5; ++t) *(LAS f32x4*)(part + ((size_t)kh * 64 + rg * 16 + fr) * 80 + 16 * t + 4 * fq) = acc[t]; }
        __syncthreads();
        if (F.tid < 64) { const int row = rb * 64 + F.tid; const LAS float* p0 = part + (size_t)F.tid * 80; const LAS float* p1 = p0 + 64 * 80;
            const float* bg = F.in[14]; const float* br = F.in[16];
            float gl[8]; int gi = 0; float gm = -3.0e38f;
#pragma unroll
            for (int c = 0; c < 8; ++c) { gl[c] = p0[c] + p1[c] + bg[c]; if (gl[c] > gm) { gm = gl[c]; gi = c; } }
            float gs = 0.f;
#pragma unroll
            for (int c = 0; c < 8; ++c) gs += __expf(gl[c] - gm);
            const float gval = 1.0f / gs;
            float el[8]; int e0 = 0; float m0 = -3.0e38f;
#pragma unroll
            for (int c = 0; c < 8; ++c) { el[c] = p0[8 + gi * 8 + c] + p1[8 + gi * 8 + c] + br[gi * 8 + c]; if (el[c] > m0) { m0 = el[c]; e0 = c; } }
            int e1 = 0; float m1 = -3.0e38f;
#pragma unroll
            for (int c = 0; c < 8; ++c) if (c != e0 && el[c] > m1) { m1 = el[c]; e1 = c; }
            const float x1v = __expf(m1 - m0); const float w0 = gval / (1.0f + x1v), w1 = gval * x1v / (1.0f + x1v);
            const int id0 = gi * 8 + e0, id1 = gi * 8 + e1;
            const unsigned s0 = atomicAdd(cnt + id0, 1u), s1 = atomicAdd(cnt + id1, 1u);
            *(int4*)(route + (size_t)row * 4) = make_int4(id0, (int)s0, id1, (int)s1); *(float2*)(gates + (size_t)row * 2) = make_float2(w0, w1); }
        __syncthreads();
    }
}

__device__ __forceinline__ void moe_tables(Frame& F) {
    LAS int* ts = (LAS int*)(F.lds + TAB_OFF); LAS int* te = ts + 65;
    if (F.tid == 0) { const unsigned* cnt = (const unsigned*)(F.ctl + CW_CNT); int t = 0;
        for (int e = 0; e < NEXP; ++e) { const int c = (int)__hip_atomic_load(cnt + e, RLX_AGENT); const int n = (c + 255) >> 8; ts[e] = t; for (int k = 0; k < n; ++k) te[t + k] = e; t += n; }
        ts[64] = t; }
    __syncthreads();
}
__device__ __forceinline__ void p6_scatter(Frame& F) {
    const int lane = lane_id();
    moe_tables(F);
    const LAS int* ts = (const LAS int*)(F.lds + TAB_OFF);
    const bf16* x1b = (const bf16*)(F.ws + WS_XB); bf16* xs = (bf16*)(F.ws + WS_XS);
    const int* route = (const int*)(F.ws + WS_ROUTE); int* pos = (int*)(F.ws + WS_ROUTE + 384 * 1024);
    const int gw = F.bid * 8 + F.wave, NGW = F.G * 8;
    for (int t = gw; t < NTOK; t += NGW) { const int4 r = *(const int4*)(route + (size_t)t * 4);
        const int p0 = ts[r.x] * 256 + r.y, p1 = ts[r.z] * 256 + r.w;
        const v4u* src = (const v4u*)(x1b + (size_t)t * DM) + lane; v4u* d0 = (v4u*)(xs + (size_t)p0 * DM) + lane; v4u* d1 = (v4u*)(xs + (size_t)p1 * DM) + lane;
#pragma unroll
        for (int j = 0; j < 4; ++j) { const v4u v = src[64 * j]; d0[64 * j] = v; d1[64 * j] = v; }
        if (lane == 0) *(int2*)(pos + (size_t)t * 2) = make_int2(p0, p1); }
}
__device__ __forceinline__ void p9_combine_ln(Frame& F) {
    const int lane = lane_id();
    float* y = (float*)(F.ws + WS_Y); bf16* x2b = (bf16*)(F.ws + WS_XB); const bf16* ys = (const bf16*)(F.ws + WS_YS);
    const float* gates = (const float*)(F.ws + WS_ROUTE + 256 * 1024); const int* pos = (const int*)(F.ws + WS_ROUTE + 384 * 1024);
    const int gw = F.bid * 8 + F.wave, NGW = F.G * 8;
    for (int t = gw; t < NTOK; t += NGW) { float* yr = y + (size_t)t * DM; const int2 pp = *(const int2*)(pos + (size_t)t * 2); const float2 gg = *(const float2*)(gates + (size_t)t * 2);
        const bf16* r0 = ys + (size_t)pp.x * DM; const bf16* r1 = ys + (size_t)pp.y * DM; f32x4 v[8];
#pragma unroll
        for (int j = 0; j < 8; ++j) { const f32x4 a = *(const f32x4*)(yr + 4 * lane + 256 * j); const v2u u0 = *(const v2u*)(r0 + 4 * lane + 256 * j), u1 = *(const v2u*)(r1 + 4 * lane + 256 * j);
            f32x4 f0 = {bf2f(u0.x & 0xffffu), bf2f(u0.x >> 16), bf2f(u0.y & 0xffffu), bf2f(u0.y >> 16)}, f1 = {bf2f(u1.x & 0xffffu), bf2f(u1.x >> 16), bf2f(u1.y & 0xffffu), bf2f(u1.y >> 16)};
            v[j] = a * ALPHA + (f0 * gg.x + f1 * gg.y); }
        ln_row(v, F.in[20], F.in[21], lane); store_row_f32_bf16(v, yr, x2b + (size_t)t * DM, lane); }
}
__device__ __forceinline__ void p11_final(Frame& F) {
    const int lane = lane_id();
    const float* y = (const float*)(F.ws + WS_Y); const bf16* T = (const bf16*)(F.ws + WS_T); const float* tss = (const float*)(F.ws + WS_TSS); const float* g = F.in[24];
    const int gw = F.bid * 8 + F.wave, NGW = F.G * 8;
    for (int t = gw; t < NTOK; t += NGW) { const float part = lane < 32 ? tss[(size_t)t * 32 + lane] : 0.f; const float rs = 1.0f / sqrtf(wave_sum(part) * (1.0f / DM) + RMS_EPS);
        const float* yr = y + (size_t)t * DM; const bf16* tr = T + (size_t)t * DM; float* orow = F.out + (size_t)t * DM;
#pragma unroll
        for (int j = 0; j < 8; ++j) { const f32x4 a = *(const f32x4*)(yr + 4 * lane + 256 * j); const v2u u = *(const v2u*)(tr + 4 * lane + 256 * j); const f32x4 gg = *(const f32x4*)(g + 4 * lane + 256 * j);
            const f32x4 tv = {bf2f(u.x & 0xffffu), bf2f(u.x >> 16), bf2f(u.y & 0xffffu), bf2f(u.y >> 16)};
            *(f32x4*)(orow + 4 * lane + 256 * j) = a + tv * rs * gg; } }
}

#ifndef MK_N_LAUNCHES
#define MK_N_LAUNCHES 12
#endif
constexpr int N_PHASES = 12;
#ifndef MK_SKIP
#define MK_SKIP 0
#endif
struct Args { const float* in[25]; float* out; unsigned char* ws; int ph_lo, ph_hi; };
__global__ void __launch_bounds__(512, 2) fwd_kernel(Args args) {
    extern __shared__ __attribute__((aligned(16))) unsigned char lds[];
    Frame F;
    F.lds = (LAS unsigned char*)lds;
    F.MISC = (volatile LAS unsigned*)(F.lds + MISC_OFF);
    F.tid = threadIdx.x; F.lane = F.tid & 63; F.wave = __builtin_amdgcn_readfirstlane(F.tid >> 6);
    F.G = gridDim.x; F.bid = blockIdx.x;
    F.ws = args.ws; F.ctl = (gu32*)(args.ws + WS_CTL); F.out = args.out;
#pragma unroll
    for (int i = 0; i < 25; ++i) F.in[i] = args.in[i];
    for (int u = F.tid; u < (LDS_BYTES - LDSCTL_OFF) / 4; u += 512) ((LAS unsigned*)(F.lds + LDSCTL_OFF))[u] = 0u;
    __syncthreads();
    const int lo = args.ph_lo, hi = args.ph_hi;
    XcdBarrier bar; bar.bar = (unsigned*)(F.ctl + CW_BAR); bar.x = 0; bar.st = nullptr;
    if (hi - lo > 1) bar = xcd_barrier_post((unsigned*)(F.ctl + CW_BAR), F.MISC + 8);
#define IN(k) (lo <= (k) && (k) < hi)
#define SEAM(k) do { if (IN(k) && IN((k) + 1)) xcd_barrier(bar); } while (0)
#define RUN(k) (IN(k) && !((MK_SKIP >> (k)) & 1))
    unsigned char* ws = F.ws;
    const int c = (int)blockIdx.x;

    if (RUN(0)) p0_prologue(F);
    SEAM(0);
    if (RUN(1)) {
        DenseSched S{(const char*)(ws + WS_XB), (const char*)(ws + WS_WIN), DM, DM, NTOK / 256, 16, F.G, c};
        EpiProj E{(bf16*)(ws + WS_QKVNA), (bf16*)(ws + WS_CQKV), (float*)(ws + WS_SSQ)};
        pg8::gemm_phase(F.lds + RING_OFF, DM, DM, DM, S, E);
        p1_kr(F);
    }
    SEAM(1);
    if (RUN(2)) {
        SchedUp S{(const char*)(ws + WS_CQKV), (const char*)(ws + WS_WUQ), F.G, c};
        EpiUp E{(bf16*)(ws + WS_Q), (bf16*)(ws + WS_KV), (const float*)(ws + WS_SSQ), (const f32x2*)(ws + WS_CS)};
        pg8::gemm_phase(F.lds + RING_OFF, 512, 1024, 512, S, E);
    }
    SEAM(2);
    if (RUN(3)) {
        const bf16* q = (const bf16*)(ws + WS_Q); const bf16* kv = (const bf16*)(ws + WS_KV); const bf16* kpe = (const bf16*)(ws + WS_KPE); bf16* o = (bf16*)(ws + WS_O);
        for (int u = c; u < NB * MH * (SEQ / 256); u += F.G) {
            int bh, qb;
            if (F.G == 256) { const int i = u >> 8, cc = u & 255, xcd = cc & 7, j = cc >> 3; bh = i * 16 + xcd * 2 + (j >> 4); qb = j & 15; } else { bh = u >> 4; qb = u & 15; }
            const int b = bh >> 3, h = bh & 7; const size_t t0 = (size_t)b * SEQ;
            mla::attn_unit(q + (t0 + qb * 256) * 1536 + h * QKD, kv + t0 * 2048 + h * NOPE, kpe + t0 * 64, kv + t0 * 2048 + 1024 + h * VD, o + (t0 + qb * 256) * 2048 + NAW + h * VD, SEQ, (char*)lds);
        }
        const bf16* qkv = (const bf16*)(ws + WS_QKVNA);
        for (int u = c; u < NB * NAH * (NROWS / 2); u += F.G) {
            int bh, rp;
            if (F.G == 256) { const int i = u >> 8, cc = u & 255; bh = i * 8 + (cc & 7); rp = cc >> 3; } else { bh = u >> 5; rp = u & 31; }
            na::na_unit(bh >> 3, bh & 7, rp, qkv, F.in[4], o, (LAS char*)F.lds);
        }
    }
    SEAM(3);
    if (RUN(4)) {
        { DenseSched S{(const char*)(ws + WS_O), (const char*)(ws + WS_WO), DM, DM, NTOK / 256, DM / 256, F.G, c};
          EpiWo E{F.in[0], (float*)(ws + WS_Y)};
          pg8::gemm_phase(F.lds + RING_OFF, DM, DM, DM, S, E); }
        { DenseSched S{(const char*)(ws + WS_PB), (const char*)(ws + WS_WPLE), PLE, PLE, NTOK / 256, DM / 256, F.G, c};
          EpiBf16 E{(bf16*)(ws + WS_E), DM};
          pg8::gemm_phase(F.lds + RING_OFF, PLE, PLE, PLE, S, E); }
    }
    SEAM(4);
    if (RUN(5)) p5_ln_router(F);
    SEAM(5);
    if (RUN(6)) p6_scatter(F);
    SEAM(6);
    if (RUN(7)) {
        moe_tables(F);
        const LAS int* ts = (const LAS int*)(F.lds + TAB_OFF);
        SchedMoe S{(const char*)(ws + WS_XS), (const char*)(ws + WS_WGU), ts + 65, DM, ts[64], 4, (size_t)1024 * DM * 2, DM, F.G, c};
        EpiGateUp E{(bf16*)(ws + WS_H)};
        pg8::gemm_phase(F.lds + RING_OFF, DM, DM, DM, S, E);
    }
    SEAM(7);
    if (RUN(8)) {
        moe_tables(F);
        const LAS int* ts = (const LAS int*)(F.lds + TAB_OFF);
        SchedMoe S{(const char*)(ws + WS_H), (const char*)(ws + WS_WD), ts + 65, DEXP, ts[64], 8, (size_t)DM * DEXP * 2, DEXP, F.G, c};
        EpiBf16 E{(bf16*)(ws + WS_YS), DM};
        pg8::gemm_phase(F.lds + RING_OFF, DEXP, DEXP, DEXP, S, E);
    }
    SEAM(8);
    if (RUN(9)) p9_combine_ln(F);
    SEAM(9);
    if (RUN(10)) {
        DenseSched S{(const char*)(ws + WS_XB), (const char*)(ws + WS_WPG), DM, DM, NTOK / 256, DM / 256, F.G, c};
        EpiPle E{(const bf16*)(ws + WS_E), (bf16*)(ws + WS_T), (float*)(ws + WS_TSS)};
        pg8::gemm_phase(F.lds + RING_OFF, DM, DM, DM, S, E);
    }
    SEAM(10);
    if (RUN(11)) p11_final(F);
#undef IN
#undef SEAM
#undef RUN
}

extern "C" void kernel_launch(void* const* d_in, const int* in_sizes, int n_in, void* d_out, int out_size, void* d_ws, size_t ws_size, hipStream_t stream) {
    static int grid = 0;
    if (grid == 0) {
        if (n_in != 25 || in_sizes[0] != NTOK * DM || out_size != NTOK * DM || ws_size < WS_END) {
            fprintf(stderr, "kernel_launch: shape mismatch: n_in %d in0 %d out %d ws %zu (need %zu)\n", n_in, n_in > 0 ? in_sizes[0] : -1, out_size, ws_size, (size_t)WS_END); grid = -1; return; }
        int dev = 0, cus = 0, per_cu = 0;
        if (hipGetDevice(&dev) != hipSuccess || hipDeviceGetAttribute(&cus, hipDeviceAttributeMultiprocessorCount, dev) != hipSuccess) { fprintf(stderr, "kernel_launch: device query failed\n"); grid = -1; return; }
        if (hipFuncSetAttribute((const void*)fwd_kernel, hipFuncAttributeMaxDynamicSharedMemorySize, LDS_BYTES) != hipSuccess) { fprintf(stderr, "kernel_launch: hipFuncSetAttribute failed\n"); grid = -1; return; }
        if (hipOccupancyMaxActiveBlocksPerMultiprocessor(&per_cu, (const void*)fwd_kernel, 512, LDS_BYTES) != hipSuccess || per_cu < 1) { fprintf(stderr, "kernel_launch: occupancy query reports %d blocks per CU\n", per_cu); (void)hipGetLastError(); grid = -1; return; }
        grid = cus;
    }
    if (grid < 0) return;
    if (hipMemsetAsync((char*)d_ws + WS_CTL, 0, CTL_ZERO_BYTES, stream) != hipSuccess) { fprintf(stderr, "kernel_launch: memset failed\n"); return; }
    Args a{};
    for (int i = 0; i < 25; ++i) a.in[i] = (const float*)d_in[i];
    a.out = (float*)d_out; a.ws = (unsigned char*)d_ws;
    for (int li = 0; li < MK_N_LAUNCHES; ++li) {
        a.ph_lo = li * N_PHASES / MK_N_LAUNCHES; a.ph_hi = (li + 1) * N_PHASES / MK_N_LAUNCHES;
        hipLaunchKernelGGL(fwd_kernel, dim3(grid), dim3(512), LDS_BYTES, stream, a);
        const hipError_t le = hipPeekAtLastError();
        if (le != hipSuccess) { fprintf(stderr, "kernel_launch: launch %d failed: %s\n", li, hipGetErrorName(le)); break; }
    }
}
```
